# Optimizing an MI355X kernel written in HIP

```python
import math
import jax, jax.numpy as jnp
from jax import lax
import numpy as np

D_MODEL = 1024
BATCH = 8
SEQ = 2048
DEPTH = 1

HEAD_DIM = 64
SB_HEADS = 8
DIFF_HEADS = 4
SB_WIDTH = SB_HEADS * HEAD_DIM
DIFF_QK_WIDTH = DIFF_HEADS * 2 * HEAD_DIM
DIFF_V_WIDTH = DIFF_HEADS * 2 * HEAD_DIM
N_BRANCHES = 2
IN_WIDTH = 3 * SB_WIDTH + 2 * DIFF_QK_WIDTH + DIFF_V_WIDTH + N_BRANCHES * D_MODEL
D_FF = 4 * D_MODEL
BLOCK_Q = 128
ROPE_THETA = 10000.0
LN_EPS = 1e-5
RMS_EPS = 1e-5
DEEPNORM_ALPHA = (2.0 * DEPTH) ** 0.25
DEEPNORM_BETA = (8.0 * DEPTH) ** -0.25

kernel_name = "hybrid_stickbreak_diffattn_gated_deepnorm"


def _lambda_init(layer_idx):
    return 0.8 - 0.6 * math.exp(-0.3 * layer_idx)


def _layer_norm(x, gain, bias):
    xf = x.astype(jnp.float32)
    mu = jnp.mean(xf, axis=-1, keepdims=True)
    var = jnp.mean(jnp.square(xf - mu), axis=-1, keepdims=True)
    y = (xf - mu) * lax.rsqrt(var + LN_EPS) * gain.astype(jnp.float32) + bias.astype(jnp.float32)
    return y.astype(x.dtype)


def _rms_norm(x, gain):
    xf = x.astype(jnp.float32)
    y = xf * lax.rsqrt(jnp.mean(jnp.square(xf), axis=-1, keepdims=True) + RMS_EPS) * gain.astype(jnp.float32)
    return y.astype(x.dtype)


def _rope_tables(seq, dim, dtype):
    inv_freq = ROPE_THETA ** (-jnp.arange(0, dim, 2, dtype=jnp.float32) / dim)
    ang = jnp.arange(seq, dtype=jnp.float32)[:, None] * inv_freq[None, :]
    return jnp.cos(ang).astype(dtype), jnp.sin(ang).astype(dtype)


def _rope(x, cos, sin):
    x1, x2 = jnp.split(x, 2, axis=-1)
    return jnp.concatenate([x1 * cos - x2 * sin, x2 * cos + x1 * sin], axis=-1)


def _stick_breaking_attention(q, k, v):
    s_len = q.shape[2]
    blk = min(BLOCK_Q, s_len)
    scale = q.shape[-1] ** -0.5
    outs = []
    for start in range(0, s_len, blk):
        end = start + blk
        qpos = start + jnp.arange(blk)
        kpos = jnp.arange(end)
        mask = kpos[None, :] < qpos[:, None]
        z = jnp.einsum('bhqd,bhkd->bhqk', q[:, :, start:end], k[:, :, :end]).astype(jnp.float32) * scale
        log_beta = jax.nn.log_sigmoid(z)
        log_1m_beta = jnp.where(mask, jax.nn.log_sigmoid(-z), 0.0)
        suffix = lax.cumsum(log_1m_beta, axis=3, reverse=True) - log_1m_beta
        a = jnp.where(mask, jnp.exp(log_beta + suffix), 0.0)
        outs.append(jnp.einsum('bhqk,bhkd->bhqd', a.astype(v.dtype), v[:, :, :end]))
    return jnp.concatenate(outs, axis=2)


def _differential_attention(q1, q2, k1, k2, v, lam):
    s_len = q1.shape[2]
    blk = min(BLOCK_Q, s_len)
    scale = q1.shape[-1] ** -0.5
    outs = []
    for start in range(0, s_len, blk):
        end = start + blk
        qpos = start + jnp.arange(blk)
        kpos = jnp.arange(end)
        mask = kpos[None, :] <= qpos[:, None]
        z1 = jnp.einsum('bhqd,bhkd->bhqk', q1[:, :, start:end], k1[:, :, :end]).astype(jnp.float32) * scale
        z2 = jnp.einsum('bhqd,bhkd->bhqk', q2[:, :, start:end], k2[:, :, :end]).astype(jnp.float32) * scale
        p1 = jax.nn.softmax(jnp.where(mask, z1, -jnp.inf), axis=-1)
        p2 = jax.nn.softmax(jnp.where(mask, z2, -jnp.inf), axis=-1)
        w = p1 - lam * p2
        outs.append(jnp.einsum('bhqk,bhkd->bhqd', w.astype(v.dtype), v[:, :, :end]))
    return jnp.concatenate(outs, axis=2)


def setup_inputs(seed: int = 0) -> dict:
    key = jax.random.key(seed)
    ks = jax.random.split(key, 17)
    f32 = jnp.float32

    def dense(k, shape, fan_in, gain=1.0):
        return jax.random.normal(k, shape, f32) * (fan_in ** -0.5) * gain

    x = jax.random.normal(ks[0], (BATCH, SEQ, D_MODEL), f32)
    w_in = dense(ks[1], (DEPTH, D_MODEL, IN_WIDTH), D_MODEL)
    col_gain = np.ones((IN_WIDTH,), np.float32)
    col_gain[2 * SB_WIDTH:3 * SB_WIDTH] = DEEPNORM_BETA
    v_b_start = 3 * SB_WIDTH + 2 * DIFF_QK_WIDTH
    col_gain[v_b_start:v_b_start + DIFF_V_WIDTH] = DEEPNORM_BETA
    w_in = w_in * jnp.asarray(col_gain)
    w_branch_a = dense(ks[2], (DEPTH, SB_WIDTH, D_MODEL), SB_WIDTH, DEEPNORM_BETA)
    w_branch_b = dense(ks[3], (DEPTH, DIFF_V_WIDTH, D_MODEL), DIFF_V_WIDTH, DEEPNORM_BETA)
    w_out = dense(ks[4], (DEPTH, D_MODEL, D_MODEL), D_MODEL, DEEPNORM_BETA)
    lambda_q1 = 0.1 * jax.random.normal(ks[5], (DEPTH, HEAD_DIM), f32)
    lambda_k1 = 0.1 * jax.random.normal(ks[6], (DEPTH, HEAD_DIM), f32)
    lambda_q2 = 0.1 * jax.random.normal(ks[7], (DEPTH, HEAD_DIM), f32)
    lambda_k2 = 0.1 * jax.random.normal(ks[8], (DEPTH, HEAD_DIM), f32)
    subln_gain = 1.0 + 0.02 * jax.random.normal(ks[9], (DEPTH, 2 * HEAD_DIM), f32)
    ln1_gain = 1.0 + 0.02 * jax.random.normal(ks[10], (DEPTH, D_MODEL), f32)
    ln1_bias = 0.02 * jax.random.normal(ks[11], (DEPTH, D_MODEL), f32)
    w_ff1 = dense(ks[12], (DEPTH, D_MODEL, D_FF), D_MODEL, DEEPNORM_BETA)
    w_ff2 = dense(ks[13], (DEPTH, D_FF, D_MODEL), D_FF, DEEPNORM_BETA)
    ln2_gain = 1.0 + 0.02 * jax.random.normal(ks[14], (DEPTH, D_MODEL), f32)
    ln2_bias = 0.02 * jax.random.normal(ks[15], (DEPTH, D_MODEL), f32)
    return {"x": x, "w_in": w_in, "w_branch_a": w_branch_a, "w_branch_b": w_branch_b, "w_out": w_out,
            "lambda_q1": lambda_q1, "lambda_k1": lambda_k1, "lambda_q2": lambda_q2, "lambda_k2": lambda_k2,
            "subln_gain": subln_gain, "ln1_gain": ln1_gain, "ln1_bias": ln1_bias,
            "w_ff1": w_ff1, "w_ff2": w_ff2, "ln2_gain": ln2_gain, "ln2_bias": ln2_bias}


def reference(x, w_in, w_branch_a, w_branch_b, w_out, lambda_q1, lambda_k1, lambda_q2, lambda_k2,
              subln_gain, ln1_gain, ln1_bias, w_ff1, w_ff2, ln2_gain, ln2_bias):
    b, s, _ = x.shape
    cos, sin = _rope_tables(s, HEAD_DIM, x.dtype)
    c_qa, c_ka, c_va = SB_WIDTH, 2 * SB_WIDTH, 3 * SB_WIDTH
    c_qb = c_va + DIFF_QK_WIDTH
    c_kb = c_qb + DIFF_QK_WIDTH
    c_vb = c_kb + DIFF_V_WIDTH
    c_ga = c_vb + D_MODEL
    for l in range(DEPTH):
        lam_init = _lambda_init(l)
        proj = jnp.einsum('bsd,de->bse', x, w_in[l])

        def heads(t, n_heads):
            return t.reshape(b, s, n_heads, -1).transpose(0, 2, 1, 3)

        qa = heads(proj[..., :c_qa], SB_HEADS)
        ka = heads(proj[..., c_qa:c_ka], SB_HEADS)
        va = heads(proj[..., c_ka:c_va], SB_HEADS)
        ya = _stick_breaking_attention(qa, ka, va)
        ya = ya.transpose(0, 2, 1, 3).reshape(b, s, SB_WIDTH)

        qb = proj[..., c_va:c_qb].reshape(b, s, DIFF_HEADS, 2, HEAD_DIM).transpose(0, 2, 3, 1, 4)
        kb = proj[..., c_qb:c_kb].reshape(b, s, DIFF_HEADS, 2, HEAD_DIM).transpose(0, 2, 3, 1, 4)
        vb = heads(proj[..., c_kb:c_vb], DIFF_HEADS)
        q1, q2 = _rope(qb[:, :, 0], cos, sin), _rope(qb[:, :, 1], cos, sin)
        k1, k2 = _rope(kb[:, :, 0], cos, sin), _rope(kb[:, :, 1], cos, sin)
        lam = (jnp.exp(jnp.sum(lambda_q1[l].astype(jnp.float32) * lambda_k1[l].astype(jnp.float32)))
               - jnp.exp(jnp.sum(lambda_q2[l].astype(jnp.float32) * lambda_k2[l].astype(jnp.float32)))
               + lam_init)
        yb = _differential_attention(q1, q2, k1, k2, vb, lam)
        yb = _rms_norm(yb, subln_gain[l]) * (1.0 - lam_init)
        yb = yb.transpose(0, 2, 1, 3).reshape(b, s, DIFF_V_WIDTH)

        gate_a = jax.nn.sigmoid(proj[..., c_vb:c_ga])
        gate_b = jax.nn.sigmoid(proj[..., c_ga:])
        merged = (gate_a * jnp.einsum('bse,ed->bsd', ya, w_branch_a[l])
                  + gate_b * jnp.einsum('bse,ed->bsd', yb, w_branch_b[l]))
        mix_out = jnp.einsum('bsd,de->bse', merged, w_out[l])
        x = _layer_norm(DEEPNORM_ALPHA * x + mix_out, ln1_gain[l], ln1_bias[l])

        h = jnp.square(jax.nn.relu(jnp.einsum('bsd,df->bsf', x, w_ff1[l])))
        ff_out = jnp.einsum('bsf,fd->bsd', h, w_ff2[l])
        x = _layer_norm(DEEPNORM_ALPHA * x + ff_out, ln2_gain[l], ln2_bias[l])
    return x
```

```cpp
#include <hip/hip_runtime.h>
#include <hip/hip_bf16.h>
#include <cstdio>
#include <cstdint>
#include <cmath>
namespace pg8 {
#define PG8_LAS __attribute__((address_space(3)))
typedef unsigned short bf16_t;
typedef short bf16x8 __attribute__((ext_vector_type(8)));
typedef float f32x4 __attribute__((ext_vector_type(4)));
typedef unsigned u32x4 __attribute__((ext_vector_type(4)));
constexpr int BM = 256, BK = 64, HALF = 128, HTB = HALF * BK * 2  , STAGE_BYTES = 8 * HTB, NXCD = 8, WGM = 8;

__host__ __device__ __forceinline__ int lds_byte(int r, int c) { const int st = (r >> 4) * 2 + (c >> 5), rr = r & 15, cc = c & 31, ob = rr * 64 + cc * 2; return st * 1024 + (ob ^ (((ob >> 9) & 1) << 5)); }
__host__ __device__ __forceinline__ void stage_rc(int b, int& R, int& C) { const int st = b / 1024, sb = b % 1024, swz = sb ^ (((sb >> 9) & 1) << 5); R = (st >> 1) * 16 + swz / 64; C = (st & 1) * 32 + (swz % 64) / 2; }
__host__ __device__ __forceinline__ int perm32(int rho) { const int n = rho >> 4, i = rho & 15; return 8 * (i >> 2) + 4 * n + (i & 3); }

struct Unit { int pm, pn; };
struct Gemm { const bf16_t* A; const bf16_t* Bt; int M, N, K; };

struct StaticOrder {
    int nM, nN, nwg, G, c;
    __host__ __device__ void init(int M, int N, int G_, int c_) { nM = M / BM; nN = N / BM; nwg = nM * nN; G = G_; c = c_; }
    __host__ __device__ bool next(int i, Unit& u) const {
        const long L = (long)i * G + c; if (L >= nwg) return false;
        int wgid = (int)L; { const int q = nwg / NXCD, r = nwg % NXCD, xcd = wgid % NXCD, off = wgid / NXCD; wgid = (xcd < r ? xcd * (q + 1) : r * (q + 1) + (xcd - r) * q) + off; }
        const int nig = WGM * nN, gid = wgid / nig, fm = gid * WGM, gsz = (nM - fm) < WGM ? (nM - fm) : WGM;
        u.pm = fm + ((wgid % nig) % gsz); u.pn = (wgid % nig) / gsz; return true;
    }
    __device__ __forceinline__ void a_ready(const Unit&) const {}
    __device__ __forceinline__ void done(const Unit&) const {}
};
typedef float f32x2c_t __attribute__((ext_vector_type(2))); typedef __bf16 bf16x2c_t __attribute__((ext_vector_type(2)));
__device__ __forceinline__ unsigned cvt_pk_bf16(float lo, float hi) { f32x2c_t v = {lo, hi}; bf16x2c_t b = __builtin_convertvector(v, bf16x2c_t); return __builtin_bit_cast(unsigned, b); }
typedef float f32x2 __attribute__((ext_vector_type(2)));
typedef unsigned u32x2 __attribute__((ext_vector_type(2)));
constexpr float kLog2e = 1.4426950408889634f;
__device__ __forceinline__ float sigmoid_f(float v) { return __builtin_amdgcn_rcpf(1.0f + __builtin_amdgcn_exp2f(-v * kLog2e)); }
__device__ __forceinline__ f32x4 bf_lo4(unsigned a, unsigned b) { return (f32x4){__uint_as_float(a << 16), __uint_as_float(a & 0xffff0000u), __uint_as_float(b << 16), __uint_as_float(b & 0xffff0000u)}; }

struct EpiProj {
    static constexpr bool PERM = true, AFTER_DRAIN = false, MID = false;
    bf16_t* P; bf16_t* G; const float* cosT; const float* sinT; float qscale;
    __device__ __forceinline__ void operator()(const f32x4 (&acc)[2][2][4][2], const Unit& u, int wr, int wc, int fr_, int fq_) const {
        int fr = fr_, fq = fq_; asm volatile("" : "+v"(fr), "+v"(fq));
        const int pn = u.pn, row0 = u.pm * BM + wr * 64 + fr, cl = wc * 32 + 8 * fq;
#if defined(P1_MASK)
        { const int sb_ = pn >= 16 ? 7 : pn >= 12 ? 6 : (pn >> 1); if (!((P1_MASK >> sb_) & 1)) return; }
#endif
        if (pn >= 12) {
            const int colt = pn * BM - 3072 + cl;
#pragma unroll
            for (int ai = 0; ai < 2; ++ai)
#pragma unroll
                for (int m = 0; m < 4; ++m) { bf16_t* rowp = G + (size_t)(row0 + ai * HALF + m * 16) * 2048 + colt;
#pragma unroll
                    for (int bj = 0; bj < 2; ++bj) { const f32x4 v0 = acc[ai][bj][m][0], v1 = acc[ai][bj][m][1]; u32x4 w;
                        w.x = cvt_pk_bf16(sigmoid_f(v0[0]), sigmoid_f(v0[1])); w.y = cvt_pk_bf16(sigmoid_f(v0[2]), sigmoid_f(v0[3]));
                        w.z = cvt_pk_bf16(sigmoid_f(v1[0]), sigmoid_f(v1[1])); w.w = cvt_pk_bf16(sigmoid_f(v1[2]), sigmoid_f(v1[3]));
                        *(u32x4*)(rowp + bj * HALF) = w; } }
        } else {
            const int sec = pn >> 1;
            if (sec == 3 || sec == 4) {
                const float sc = sec == 3 ? qscale : 1.f;
                const int g = (wc & 1) * 4 + fq, hb = pn * BM + (wc >> 1) * 64;
#pragma unroll
                for (int ai = 0; ai < 2; ++ai)
#pragma unroll
                    for (int m = 0; m < 4; ++m) { const int row = row0 + ai * HALF + m * 16, s = row & 2047;
                        const f32x4 cs = *(const f32x4*)(cosT + s * 32 + 4 * g), sn = *(const f32x4*)(sinT + s * 32 + 4 * g);
                        bf16_t* rowp = P + (size_t)row * 3072 + hb + 4 * g;
#pragma unroll
                        for (int bj = 0; bj < 2; ++bj) { const f32x4 v0 = acc[ai][bj][m][0], v1 = acc[ai][bj][m][1];
                            const f32x4 o1 = (v0 * cs - v1 * sn) * sc, o2 = (v1 * cs + v0 * sn) * sc; u32x2 a, b;
                            a.x = cvt_pk_bf16(o1[0], o1[1]); a.y = cvt_pk_bf16(o1[2], o1[3]); b.x = cvt_pk_bf16(o2[0], o2[1]); b.y = cvt_pk_bf16(o2[2], o2[3]);
                            *(u32x2*)(rowp + bj * HALF) = a; *(u32x2*)(rowp + bj * HALF + 32) = b; } }
            } else {
                const float sc = sec == 0 ? qscale : 1.f; const int colt = pn * BM + cl;
#pragma unroll
                for (int ai = 0; ai < 2; ++ai)
#pragma unroll
                    for (int m = 0; m < 4; ++m) { bf16_t* rowp = P + (size_t)(row0 + ai * HALF + m * 16) * 3072 + colt;
#pragma unroll
                        for (int bj = 0; bj < 2; ++bj) { const f32x4 v0 = acc[ai][bj][m][0] * sc, v1 = acc[ai][bj][m][1] * sc; u32x4 w;
                            w.x = cvt_pk_bf16(v0[0], v0[1]); w.y = cvt_pk_bf16(v0[2], v0[3]); w.z = cvt_pk_bf16(v1[0], v1[1]); w.w = cvt_pk_bf16(v1[2], v1[3]);
                            *(u32x4*)(rowp + bj * HALF) = w; } }
            }
        }
    }
};

struct EpiBranch {
    static constexpr bool PERM = true, AFTER_DRAIN = false, MID = true;
    const bf16_t* G; bf16_t* O;
    __device__ __forceinline__ void mid(f32x4 (&acc)[2][2][4][2], const Unit& u, int wr, int wc, int fr_, int fq_) const {
        int fr = fr_, fq = fq_; asm volatile("" : "+v"(fr), "+v"(fq));
        const int row0 = u.pm * BM + wr * 64 + fr, colt = u.pn * BM + wc * 32 + 8 * fq;
#pragma unroll
        for (int ai = 0; ai < 2; ++ai)
#pragma unroll
            for (int m = 0; m < 4; ++m) { const bf16_t* gp = G + (size_t)(row0 + ai * HALF + m * 16) * 2048 + colt;
#pragma unroll
                for (int bj = 0; bj < 2; ++bj) { const u32x4 a = *(const u32x4*)(gp + bj * HALF), b = *(const u32x4*)(gp + 1024 + bj * HALF);
                    const f32x4 a0 = bf_lo4(a.x, a.y), a1 = bf_lo4(a.z, a.w), b0 = bf_lo4(b.x, b.y), b1 = bf_lo4(b.z, b.w); f32x4 r0, r1;
#pragma unroll
                    for (int i = 0; i < 4; ++i) { r0[i] = a0[i] * __builtin_amdgcn_rcpf(__builtin_fmaxf(b0[i], 1e-30f)); r1[i] = a1[i] * __builtin_amdgcn_rcpf(__builtin_fmaxf(b1[i], 1e-30f)); }
                    acc[ai][bj][m][0] *= r0; acc[ai][bj][m][1] *= r1; } }
    }
    __device__ __forceinline__ void operator()(const f32x4 (&acc)[2][2][4][2], const Unit& u, int wr, int wc, int fr_, int fq_) const {
        int fr = fr_, fq = fq_; asm volatile("" : "+v"(fr), "+v"(fq));
        const int row0 = u.pm * BM + wr * 64 + fr, colt = u.pn * BM + wc * 32 + 8 * fq;
#pragma unroll
        for (int ai = 0; ai < 2; ++ai)
#pragma unroll
            for (int m = 0; m < 4; ++m) { const size_t row = (size_t)(row0 + ai * HALF + m * 16); const bf16_t* gp = G + row * 2048 + 1024 + colt; bf16_t* op = O + row * 1024 + colt;
#pragma unroll
                for (int bj = 0; bj < 2; ++bj) { const u32x4 b = *(const u32x4*)(gp + bj * HALF); const f32x4 v0 = acc[ai][bj][m][0] * bf_lo4(b.x, b.y), v1 = acc[ai][bj][m][1] * bf_lo4(b.z, b.w); u32x4 w;
                    w.x = cvt_pk_bf16(v0[0], v0[1]); w.y = cvt_pk_bf16(v0[2], v0[3]); w.z = cvt_pk_bf16(v1[0], v1[1]); w.w = cvt_pk_bf16(v1[2], v1[3]);
                    *(u32x4*)(op + bj * HALF) = w; } }
    }
};

struct EpiResF32 {
    static constexpr bool PERM = false, AFTER_DRAIN = false, MID = false;
    const float* base; float* out; int ldc; float alpha;
    __device__ __forceinline__ void operator()(const f32x4 (&acc)[2][2][4][2], const Unit& u, int wr, int wc, int fr_, int fq_) const {
        int fr = fr_, fq = fq_; asm volatile("" : "+v"(fr), "+v"(fq));
        const int row0 = u.pm * BM + wr * 64 + fr, col0 = u.pn * BM + wc * 32 + 4 * fq;
#pragma unroll
        for (int ai = 0; ai < 2; ++ai)
#pragma unroll
            for (int m = 0; m < 4; ++m) { const size_t off = (size_t)(row0 + ai * HALF + m * 16) * ldc + col0;
#pragma unroll
                for (int bj = 0; bj < 2; ++bj)
#pragma unroll
                    for (int n = 0; n < 2; ++n) { const f32x4 bs = *(const f32x4*)(base + off + bj * HALF + n * 16); *(f32x4*)(out + off + bj * HALF + n * 16) = bs * alpha + acc[ai][bj][m][n]; } }
    }
};

struct EpiRelu2 {
    static constexpr bool PERM = true, AFTER_DRAIN = false, MID = false;
    bf16_t* O; int ldc;
    __device__ __forceinline__ void operator()(const f32x4 (&acc)[2][2][4][2], const Unit& u, int wr, int wc, int fr_, int fq_) const {
        int fr = fr_, fq = fq_; asm volatile("" : "+v"(fr), "+v"(fq));
        const int row0 = u.pm * BM + wr * 64 + fr, colt = u.pn * BM + wc * 32 + 8 * fq;
#pragma unroll
        for (int ai = 0; ai < 2; ++ai)
#pragma unroll
            for (int m = 0; m < 4; ++m) { bf16_t* rowp = O + (size_t)(row0 + ai * HALF + m * 16) * ldc + colt;
#pragma unroll
                for (int bj = 0; bj < 2; ++bj) { f32x4 v0 = acc[ai][bj][m][0], v1 = acc[ai][bj][m][1];
#pragma unroll
                    for (int i = 0; i < 4; ++i) { v0[i] = __builtin_fmaxf(v0[i], 0.f); v1[i] = __builtin_fmaxf(v1[i], 0.f); }
                    v0 = v0 * v0; v1 = v1 * v1; u32x4 w;
                    w.x = cvt_pk_bf16(v0[0], v0[1]); w.y = cvt_pk_bf16(v0[2], v0[3]); w.z = cvt_pk_bf16(v1[0], v1[1]); w.w = cvt_pk_bf16(v1[2], v1[3]);
                    *(u32x4*)(rowp + bj * HALF) = w; } }
    }
};

template <class Epi, class Sched, bool ALIGN_EPI = false, bool SP2 = false>
__device__ __forceinline__ void gemm_phase(PG8_LAS unsigned char* lds, const Gemm g, const Sched& S, const Epi& E) {
    int tid_ = threadIdx.x; asm volatile("" : "+v"(tid_));
    const int tid = tid_, wid = __builtin_amdgcn_readfirstlane(tid >> 6), lane = tid & 63, wr = wid >> 2, wc = wid & 3, fr = lane & 15, fq = lane >> 4;
    const int K = g.K, nt = K / BK;
    unsigned voffA[2], voffB[2];
#pragma unroll
    for (int i = 0; i < 2; ++i) { int R, C; stage_rc(tid * 16 + i * 8192, R, C); const int Rb = Epi::PERM ? ((R & ~31) + perm32(R & 31)) : R;
        voffA[i] = (unsigned)(R * K + C) * 2u; voffB[i] = (unsigned)(Rb * K + C) * 2u; }
    const size_t kstep = (size_t)(BK * 2);
    const size_t hstep = (size_t)HALF * K * 2;
    const size_t tstep = 2 * hstep;
    const unsigned ldsw = (unsigned)wid * 1024u;
    const int aoff = lds_byte(wr * 64 + fr, fq * 8), boff = lds_byte(wc * 32 + fr, fq * 8);
#define PG8_SA(b, h) (((b) * 2 + (h)) * HTB)
#define PG8_SB(b, h) ((4 + (b) * 2 + (h)) * HTB)
#define PG8_STAGE(bufoff, gbase, voff) do { _Pragma("unroll") for (int _i = 0; _i < 2; ++_i) \
        __builtin_amdgcn_global_load_lds((const unsigned*)((const char*)(gbase) + (voff)[_i]), (PG8_LAS unsigned*)(lds + (bufoff) + ldsw + _i * 8192), 16, 0, 0); } while (0)
#define PG8_LDA(dst, b, h) do { _Pragma("unroll") for (int m = 0; m < 4; ++m) _Pragma("unroll") for (int k = 0; k < 2; ++k) dst[m][k] = *(const PG8_LAS bf16x8*)(lds + PG8_SA(b, h) + aoff + m * 2048 + k * 1024); } while (0)
#define PG8_LDB(dst, b, h) do { _Pragma("unroll") for (int n = 0; n < 2; ++n) _Pragma("unroll") for (int k = 0; k < 2; ++k) dst[n][k] = *(const PG8_LAS bf16x8*)(lds + PG8_SB(b, h) + boff + n * 2048 + k * 1024); } while (0)
#define PG8_MMA(ai, bj, At, Bt) do { __builtin_amdgcn_s_setprio(1); _Pragma("unroll") for (int m = 0; m < 4; ++m) _Pragma("unroll") for (int n = 0; n < 2; ++n) _Pragma("unroll") for (int k = 0; k < 2; ++k) \
        acc[ai][bj][m][n] = __builtin_amdgcn_mfma_f32_16x16x32_bf16(Bt[n][k], At[m][k], acc[ai][bj][m][n], 0, 0, 0); __builtin_amdgcn_s_setprio(0); } while (0)
#define PG8_WAIT_V(n) asm volatile("s_waitcnt vmcnt(" #n ")" ::: "memory")
#define PG8_WAIT_L(n) asm volatile("s_waitcnt lgkmcnt(" #n ")" ::: "memory")
#define PG8_BAR __builtin_amdgcn_s_barrier()
#define PG8_SCHED __builtin_amdgcn_sched_barrier(0)
    Unit cur, nxt; int ui = 0;
    if (!S.next(0, cur)) return;
    f32x4 acc[2][2][4][2];
#pragma unroll
    for (int a = 0; a < 2; ++a)
#pragma unroll
        for (int b = 0; b < 2; ++b)
#pragma unroll
            for (int m = 0; m < 4; ++m)
#pragma unroll
                for (int n = 0; n < 2; ++n) acc[a][b][m][n] = (f32x4){0.f, 0.f, 0.f, 0.f};
    bf16x8 At[4][2], B0[2][2], B1[2][2];
    const char* cA = (const char*)g.A + (size_t)cur.pm * tstep; const char* cB = (const char*)g.Bt + (size_t)cur.pn * tstep;
    S.a_ready(cur);
    if constexpr (SP2) {
        PG8_STAGE(PG8_SB(0, 0), cB, voffB); PG8_STAGE(PG8_SB(0, 1), cB + hstep, voffB); PG8_STAGE(PG8_SA(0, 0), cA, voffA); PG8_STAGE(PG8_SA(0, 1), cA + hstep, voffA);
        if (wr == 1) PG8_BAR;
        PG8_WAIT_V(2); PG8_BAR;
        PG8_STAGE(PG8_SB(1, 0), cB + kstep, voffB); PG8_STAGE(PG8_SA(1, 0), cA + kstep, voffA); PG8_STAGE(PG8_SB(1, 1), cB + hstep + kstep, voffB);
        PG8_WAIT_V(6); PG8_BAR;
    } else {
        PG8_STAGE(PG8_SB(0, 0), cB, voffB); PG8_STAGE(PG8_SA(0, 0), cA, voffA); PG8_STAGE(PG8_SB(0, 1), cB + hstep, voffB); PG8_STAGE(PG8_SA(0, 1), cA + hstep, voffA);
        if (wr == 1) PG8_BAR;
        PG8_WAIT_V(4); PG8_BAR;
        PG8_STAGE(PG8_SB(1, 0), cB + kstep, voffB); PG8_STAGE(PG8_SA(1, 0), cA + kstep, voffA); PG8_STAGE(PG8_SB(1, 1), cB + hstep + kstep, voffB);
        PG8_WAIT_V(6); PG8_BAR;
    }
    for (;;) {
        const bool has_next = S.next(ui + 1, nxt);
        const char* nA = has_next ? (const char*)g.A + (size_t)nxt.pm * tstep : cA; const char* nB = has_next ? (const char*)g.Bt + (size_t)nxt.pn * tstep : cB;
        for (int t = 0; t < nt; t += 2) {
            if constexpr (Epi::MID) { if (t == (nt >> 1)) E.mid(acc, cur, wr, wc, fr, fq); }
            const bool last = (t == nt - 2);
            const char* a1 = cA + (size_t)(t + 1) * kstep;
            const char* a2 = last ? nA : cA + (size_t)(t + 2) * kstep; const char* b2 = last ? nB : cB + (size_t)(t + 2) * kstep;
            const char* a3 = a2 + kstep; const char* b3 = b2 + kstep;
            if (last && has_next) S.a_ready(nxt);
            if constexpr (SP2) {
            PG8_LDB(B0, 0, 0); PG8_LDB(B1, 0, 1); PG8_SCHED; PG8_LDA(At, 0, 0); PG8_STAGE(PG8_SA(1, 1), a1 + hstep, voffA);
            PG8_WAIT_V(8); PG8_WAIT_L(0); PG8_BAR; PG8_MMA(0, 0, At, B0); PG8_MMA(0, 1, At, B1); PG8_BAR; PG8_SCHED;
            PG8_LDA(At, 0, 1); PG8_STAGE(PG8_SB(0, 0), b2, voffB); PG8_STAGE(PG8_SB(0, 1), b2 + hstep, voffB); PG8_STAGE(PG8_SA(0, 0), a2, voffA);
            PG8_WAIT_V(8); PG8_WAIT_L(0); PG8_BAR; PG8_MMA(1, 0, At, B0); PG8_MMA(1, 1, At, B1); PG8_BAR; PG8_SCHED;
            PG8_LDB(B0, 1, 0); PG8_LDB(B1, 1, 1); PG8_SCHED; PG8_LDA(At, 1, 0); PG8_STAGE(PG8_SA(0, 1), a2 + hstep, voffA);
            PG8_WAIT_V(8); PG8_WAIT_L(0); PG8_BAR; PG8_MMA(0, 0, At, B0); PG8_MMA(0, 1, At, B1); PG8_BAR; PG8_SCHED;
            PG8_LDA(At, 1, 1); PG8_STAGE(PG8_SB(1, 0), b3, voffB); PG8_STAGE(PG8_SB(1, 1), b3 + hstep, voffB); PG8_STAGE(PG8_SA(1, 0), a3, voffA);
            PG8_WAIT_V(8); PG8_WAIT_L(0); PG8_BAR; PG8_MMA(1, 0, At, B0); PG8_MMA(1, 1, At, B1); PG8_BAR; PG8_SCHED;
            } else {
            PG8_LDB(B0, 0, 0); PG8_SCHED; PG8_LDA(At, 0, 0); PG8_STAGE(PG8_SA(1, 1), a1 + hstep, voffA);
            PG8_WAIT_L(8); PG8_BAR; PG8_WAIT_L(0); PG8_MMA(0, 0, At, B0); PG8_BAR; PG8_SCHED;
            PG8_LDB(B1, 0, 1); PG8_STAGE(PG8_SB(0, 0), b2, voffB);
            PG8_BAR; PG8_WAIT_L(0); PG8_MMA(0, 1, At, B1); PG8_BAR;
            PG8_LDA(At, 0, 1); PG8_STAGE(PG8_SA(0, 0), a2, voffA);
            PG8_BAR; PG8_WAIT_L(0); PG8_MMA(1, 0, At, B0); PG8_BAR; PG8_SCHED;
            PG8_STAGE(PG8_SB(0, 1), b2 + hstep, voffB);
            PG8_WAIT_V(6); PG8_BAR; PG8_MMA(1, 1, At, B1); PG8_BAR;
            PG8_LDB(B0, 1, 0); PG8_SCHED; PG8_LDA(At, 1, 0); PG8_STAGE(PG8_SA(0, 1), a2 + hstep, voffA);
            PG8_WAIT_L(8); PG8_BAR; PG8_WAIT_L(0); PG8_MMA(0, 0, At, B0); PG8_BAR; PG8_SCHED;
            PG8_LDB(B1, 1, 1); PG8_STAGE(PG8_SB(1, 0), b3, voffB);
            PG8_BAR; PG8_WAIT_L(0); PG8_MMA(0, 1, At, B1); PG8_BAR;
            PG8_LDA(At, 1, 1); PG8_STAGE(PG8_SA(1, 0), a3, voffA);
            PG8_BAR; PG8_WAIT_L(0); PG8_MMA(1, 0, At, B0); PG8_BAR; PG8_SCHED;
            PG8_STAGE(PG8_SB(1, 1), b3 + hstep, voffB);
            PG8_WAIT_V(6); PG8_BAR; PG8_MMA(1, 1, At, B1); PG8_BAR;
            }
        }
        if constexpr (ALIGN_EPI) { if (wr == 0) PG8_BAR; }
        if constexpr (!Epi::AFTER_DRAIN) { E(acc, cur, wr, wc, fr, fq); S.done(cur); }
        if (!has_next) break;
#pragma unroll
        for (int a = 0; a < 2; ++a)
#pragma unroll
            for (int b = 0; b < 2; ++b)
#pragma unroll
                for (int m = 0; m < 4; ++m)
#pragma unroll
                    for (int n = 0; n < 2; ++n) acc[a][b][m][n] = (f32x4){0.f, 0.f, 0.f, 0.f};
        cur = nxt; cA = nA; cB = nB; ++ui;
        if constexpr (ALIGN_EPI) { if (wr == 1) PG8_BAR; }
    }
    PG8_WAIT_V(0);
    if constexpr (!ALIGN_EPI) { if (wr == 0) PG8_BAR; }
    PG8_BAR;
    if constexpr (Epi::AFTER_DRAIN) { E.fused(acc, cur, wr, wc, fr, fq, lds, wid, lane); S.done(cur); }
#undef PG8_SA
#undef PG8_SB
#undef PG8_STAGE
#undef PG8_LDA
#undef PG8_LDB
#undef PG8_MMA
#undef PG8_WAIT_V
#undef PG8_WAIT_L
#undef PG8_BAR
#undef PG8_SCHED
}
}
namespace att {
#define ALAS __attribute__((address_space(3)))
typedef unsigned short bf16_t;
typedef short bf16x8 __attribute__((ext_vector_type(8)));
typedef short s16x4 __attribute__((ext_vector_type(4)));
typedef float f32x16 __attribute__((ext_vector_type(16)));
typedef float f32x4 __attribute__((ext_vector_type(4)));
typedef unsigned u32x4 __attribute__((ext_vector_type(4)));
typedef ALAS char* lds_ptr;
typedef ALAS const char* lds_cptr;
constexpr int SEQ = 2048, PITCH = 3072, YP = 1024;
constexpr float C2 = 0.125f * 1.4426950408889634f;
constexpr int BUFB = 32768, L_K = 0, L_V = 16384, L_STG = 65536, STG_DIFF = 16896, L_WS = L_STG + 4 * STG_DIFF, L_UNIT = L_WS + 8 * 256, L_FLAG = L_UNIT + 16, ATT_LDS = L_FLAG + 64;
__device__ __forceinline__ int crow(int r, int hi) { return (r & 3) + 8 * (r >> 2) + 4 * hi; }
typedef float f32x2_t __attribute__((ext_vector_type(2))); typedef __bf16 bf16x2_t __attribute__((ext_vector_type(2)));
__device__ __forceinline__ unsigned cvtpk(float lo, float hi) { f32x2_t v = {lo, hi}; bf16x2_t b = __builtin_convertvector(v, bf16x2_t); return __builtin_bit_cast(unsigned, b); }
typedef short v4i16_t __attribute__((ext_vector_type(4)));
__device__ __forceinline__ s16x4 vtr(lds_cptr p) { return __builtin_bit_cast(s16x4, __builtin_amdgcn_ds_read_tr16_b64_v4i16((ALAS v4i16_t*)p)); }
#define ATT_MFMA(a, b, c) __builtin_amdgcn_mfma_f32_32x32x16_bf16(a, b, c, 0, 0, 0)
__device__ __forceinline__ int krow(int kk) { const int hi = kk >> 5, u = (kk >> 4) & 1, r = kk & 15; return 32 * u + (r & 3) + 8 * (r >> 2) + 4 * hi; }

__device__ __forceinline__ void qk_tile(f32x16& p0, f32x16& p1, lds_cptr kb, const bf16x8 (&qr)[4], int r32, int hi) {
    const int swz = (r32 >> 1) & 7; lds_cptr kp = kb + r32 * 128;
#pragma unroll
    for (int ks = 0; ks < 4; ++ks) { const int off = ((2 * ks + hi) ^ swz) << 4;
        const bf16x8 a0 = *(ALAS const bf16x8*)(kp + off), a1 = *(ALAS const bf16x8*)(kp + 4096 + off);
        p0 = ATT_MFMA(a0, qr[ks], p0); p1 = ATT_MFMA(a1, qr[ks], p1); }
}
template <int ND> __device__ __forceinline__ void pv_tile(f32x16 (&o)[ND], lds_cptr vb, const bf16x8 (&pa)[4], int lane) {
    const int hi = lane >> 5, qq = (lane & 15) >> 2, x = ((lane >> 4) & 1) * 32 + (lane & 3) * 8, sw = (qq >> 1) & 1;
    lds_cptr v0 = vb + (32 * hi + qq) * 128 + x;
#pragma unroll
    for (int dd = 0; dd < ND; ++dd) { lds_cptr vp = v0 + (dd >> 1) * 8192 + (((dd & 1) ^ sw) << 6);
#pragma unroll
        for (int k4 = 0; k4 < 4; ++k4) { const s16x4 lo = vtr(vp + k4 * 1024), hh = vtr(vp + k4 * 1024 + 512);
            const bf16x8 vf = (bf16x8){lo[0], lo[1], lo[2], lo[3], hh[0], hh[1], hh[2], hh[3]};
            o[dd] = ATT_MFMA(pa[k4], vf, o[dd]); } }
}
__device__ __forceinline__ void pack_p(bf16x8 (&pa)[4], const f32x16& a0, const f32x16& a1) {
    u32x4 w;
    w.x = cvtpk(a0[0], a0[1]); w.y = cvtpk(a0[2], a0[3]); w.z = cvtpk(a0[4], a0[5]); w.w = cvtpk(a0[6], a0[7]); pa[0] = __builtin_bit_cast(bf16x8, w);
    w.x = cvtpk(a0[8], a0[9]); w.y = cvtpk(a0[10], a0[11]); w.z = cvtpk(a0[12], a0[13]); w.w = cvtpk(a0[14], a0[15]); pa[1] = __builtin_bit_cast(bf16x8, w);
    w.x = cvtpk(a1[0], a1[1]); w.y = cvtpk(a1[2], a1[3]); w.z = cvtpk(a1[4], a1[5]); w.w = cvtpk(a1[6], a1[7]); pa[2] = __builtin_bit_cast(bf16x8, w);
    w.x = cvtpk(a1[8], a1[9]); w.y = cvtpk(a1[10], a1[11]); w.z = cvtpk(a1[12], a1[13]); w.w = cvtpk(a1[14], a1[15]); pa[3] = __builtin_bit_cast(bf16x8, w);
}
__device__ __forceinline__ float swap_other(float v, int hi) { auto rr = __builtin_amdgcn_permlane32_swap(__float_as_uint(v), __float_as_uint(v), false, false); return __uint_as_float(hi ? rr[0] : rr[1]); }

template <bool MASK> __device__ __forceinline__ void sb_weights(f32x16& p0, f32x16& p1, float& R, int lim, int hi) {
    f32x16 m0, m1;
#pragma unroll
    for (int r = 0; r < 16; ++r) {
        const float z0 = __builtin_fmaxf(p0[r], -115.f), z1 = __builtin_fmaxf(p1[r], -115.f);
        const float e0 = __builtin_amdgcn_exp2f(-z0), e1 = __builtin_amdgcn_exp2f(-z1);
        float s0 = __builtin_amdgcn_rcpf(1.0f + e0), s1 = __builtin_amdgcn_rcpf(1.0f + e1);
        float n0 = e0 * s0, n1 = e1 * s1;
        if (MASK) { const bool v0 = r < lim, v1 = (16 + r) < lim; s0 = v0 ? s0 : 0.f; n0 = v0 ? n0 : 1.f; s1 = v1 ? s1 : 0.f; n1 = v1 ? n1 : 1.f; }
        p0[r] = s0; p1[r] = s1; m0[r] = n0; m1[r] = n1;
    }
    float run = 1.f;
#pragma unroll
    for (int r = 15; r >= 0; --r) { p1[r] *= run; run *= m1[r]; }
#pragma unroll
    for (int r = 15; r >= 0; --r) { p0[r] *= run; run *= m0[r]; }
    const float oth = swap_other(run, hi);
    const float mult = hi ? R : R * oth;
#pragma unroll
    for (int r = 0; r < 16; ++r) { p0[r] *= mult; p1[r] *= mult; }
    R = R * run * oth;
}

template <bool EARLY> __device__ __forceinline__ void sb_unit(int b, int h, int qb, const bf16_t* __restrict__ P, bf16_t* __restrict__ Y, lds_ptr lds) {
    int tid_ = threadIdx.x; asm volatile("" : "+v"(tid_));
    const int tid = tid_, lane = tid & 63, r32 = lane & 31, hi = lane >> 5; const int wid = __builtin_amdgcn_readfirstlane(tid >> 6);
    const size_t rowbase = (size_t)b * SEQ; const int q0 = qb * 256;
    const bf16_t* Qw = P + (rowbase + q0 + wid * 32 + r32) * PITCH + h * 64;
    bf16x8 qr[4];
#pragma unroll
    for (int ks = 0; ks < 4; ++ks) qr[ks] = *(const bf16x8*)(Qw + ks * 16 + hi * 8);
    const bf16_t* Kg = P + rowbase * PITCH + 512 + h * 64; const bf16_t* Vg = P + rowbase * PITCH + 1024 + h * 64;
    const int lkey = tid >> 3, lch = tid & 7, rho = krow(lkey);
    const int kdst = L_K + rho * 128 + ((lch ^ ((rho >> 1) & 7)) << 4), vdst = L_V + lkey * 128 + ((lch << 4) ^ (((lkey >> 1) & 1) << 6));
    const size_t goff = (size_t)lkey * PITCH + lch * 8;
    const int NT = 4 * qb + 4;
    f32x16 o[2]; o[0] = f32x16{}; o[1] = f32x16{}; float R = 1.f;
    const int qg = q0 + wid * 32 + r32;
    ALAS unsigned* flags = (ALAS unsigned*)(lds + L_FLAG);
    u32x4 kreg = *(const u32x4*)(Kg + (size_t)(NT - 1) * 64 * PITCH + goff), vreg = *(const u32x4*)(Vg + (size_t)(NT - 1) * 64 * PITCH + goff);
    *(ALAS u32x4*)(lds + kdst) = kreg; *(ALAS u32x4*)(lds + vdst) = vreg;
    __syncthreads();
    for (int it = 0; it < NT; ++it) {
        const int t = NT - 1 - it, cur = (it & 1) * BUFB;
        if (EARLY && it > 0) { const ALAS unsigned* f = flags + ((it - 1) & 1) * 8; unsigned a = f[0] & f[1] & f[2] & f[3] & f[4] & f[5] & f[6] & f[7]; if (__builtin_amdgcn_readfirstlane(a) != 0u) break; }
        const bool more = it + 1 < NT;
        if (more) { kreg = *(const u32x4*)(Kg + (size_t)(t - 1) * 64 * PITCH + goff); vreg = *(const u32x4*)(Vg + (size_t)(t - 1) * 64 * PITCH + goff); }
        if (64 * t < q0 + wid * 32 + 31) {
            f32x16 p0 = f32x16{}, p1 = f32x16{};
            qk_tile(p0, p1, (lds_cptr)(lds + cur + L_K), qr, r32, hi);
            if (64 * t + 63 >= q0 + wid * 32) sb_weights<true>(p0, p1, R, qg - 64 * t - 32 * hi, hi); else sb_weights<false>(p0, p1, R, 0, hi);
            bf16x8 pa[4]; pack_p(pa, p0, p1);
            pv_tile<2>(o, (lds_cptr)(lds + cur + L_V), pa, lane);
        }
        if (EARLY) { const bool z = __all(R == 0.f); if (lane == 0) flags[(it & 1) * 8 + wid] = z ? 1u : 0u; }
        if (more) { *(ALAS u32x4*)(lds + (cur ^ BUFB) + kdst) = kreg; *(ALAS u32x4*)(lds + (cur ^ BUFB) + vdst) = vreg; }
        __syncthreads();
    }
    ALAS bf16_t* stg = (ALAS bf16_t*)(lds + L_STG + wid * 4096);
#pragma unroll
    for (int r = 0; r < 16; ++r) { const int orow = crow(r, hi);
#pragma unroll
        for (int d0 = 0; d0 < 2; ++d0) stg[orow * 64 + d0 * 32 + r32] = (bf16_t)(cvtpk(o[d0][r], 0.f) & 0xffffu); }
    asm volatile("s_waitcnt lgkmcnt(0)" ::: "memory");
    bf16_t* Yw = Y + (rowbase + q0 + wid * 32) * YP + h * 64;
#pragma unroll
    for (int i = 0; i < 4; ++i) { const int row = i * 8 + (lane >> 3), ch = lane & 7; const u32x4 v = *(ALAS const u32x4*)(stg + row * 64 + ch * 8); *(u32x4*)(Yw + (size_t)row * YP + ch * 8) = v; }
    __syncthreads();
}

__device__ __forceinline__ float rowmax32(const f32x16& p0, const f32x16& p1, int hi) {
    float a = __builtin_fmaxf(p0[0], p1[0]);
#pragma unroll
    for (int r = 1; r < 16; ++r) a = __builtin_fmaxf(a, __builtin_fmaxf(p0[r], p1[r]));
    return __builtin_fmaxf(a, swap_other(a, hi));
}
__device__ __forceinline__ float wave_sum64(float v) {
#pragma unroll
    for (int o = 1; o < 64; o <<= 1) v += __shfl_xor(v, o);
    return v;
}
__device__ __forceinline__ void diff_unit(int b, int h, int qb, const bf16_t* __restrict__ P, bf16_t* __restrict__ Y, lds_ptr lds, float lam, const float* __restrict__ gain) {
    int tid_ = threadIdx.x; asm volatile("" : "+v"(tid_));
    const int tid = tid_, lane = tid & 63, r32 = lane & 31, hi = lane >> 5; const int wid = __builtin_amdgcn_readfirstlane(tid >> 6);
    const int path = wid >> 2, sub = wid & 3;
    const size_t rowbase = (size_t)b * SEQ; const int q0 = qb * 128;
    const bf16_t* Qw = P + (rowbase + q0 + sub * 32 + r32) * PITCH + 1536 + h * 128 + path * 64;
    bf16x8 qr[4];
#pragma unroll
    for (int ks = 0; ks < 4; ++ks) qr[ks] = *(const bf16x8*)(Qw + ks * 16 + hi * 8);
    const bf16_t* Kg = P + rowbase * PITCH + 2048 + h * 128; const bf16_t* Vg = P + rowbase * PITCH + 2560 + h * 128;
    int kdst[2], vdst[2]; size_t goff[2];
#pragma unroll
    for (int i = 0; i < 2; ++i) { const int idx = tid + 512 * i, key = idx >> 4, c16 = idx & 15, sb = c16 >> 3, ch = c16 & 7, rho = krow(key);
        kdst[i] = L_K + sb * 8192 + rho * 128 + ((ch ^ ((rho >> 1) & 7)) << 4); vdst[i] = L_V + sb * 8192 + key * 128 + ((ch << 4) ^ (((key >> 1) & 1) << 6));
        goff[i] = (size_t)key * PITCH + c16 * 8; }
    const int NT = 2 * qb + 2;
    f32x16 o[4]; o[0] = f32x16{}; o[1] = f32x16{}; o[2] = f32x16{}; o[3] = f32x16{};
    float mrun = -1e30f, lsum = 0.f;
    const int qg = q0 + sub * 32 + r32;
    ALAS float* wsf = (ALAS float*)(lds + L_WS + wid * 256);
    u32x4 kreg[2], vreg[2];
#pragma unroll
    for (int i = 0; i < 2; ++i) { kreg[i] = *(const u32x4*)(Kg + goff[i]); vreg[i] = *(const u32x4*)(Vg + goff[i]); }
#pragma unroll
    for (int i = 0; i < 2; ++i) { *(ALAS u32x4*)(lds + kdst[i]) = kreg[i]; *(ALAS u32x4*)(lds + vdst[i]) = vreg[i]; }
    __syncthreads();
    for (int t = 0; t < NT; ++t) {
        const int cur = (t & 1) * BUFB; const bool more = t + 1 < NT;
        if (more) {
#pragma unroll
            for (int i = 0; i < 2; ++i) { kreg[i] = *(const u32x4*)(Kg + (size_t)(t + 1) * 64 * PITCH + goff[i]); vreg[i] = *(const u32x4*)(Vg + (size_t)(t + 1) * 64 * PITCH + goff[i]); } }
        if (64 * t <= q0 + sub * 32 + 31) {
            f32x16 p0 = f32x16{}, p1 = f32x16{};
            qk_tile(p0, p1, (lds_cptr)(lds + cur + L_K + path * 8192), qr, r32, hi);
            if (64 * t + 63 > q0 + sub * 32) { const int lim = qg - 64 * t - 32 * hi;
#pragma unroll
                for (int r = 0; r < 16; ++r) { if (r > lim) p0[r] = -INFINITY; if (16 + r > lim) p1[r] = -INFINITY; } }
            const float rm = rowmax32(p0, p1, hi);
            if (__any(rm > mrun)) {
                const float mn = __builtin_fmaxf(mrun, rm), al = __builtin_amdgcn_exp2f(mrun - mn);
                lsum *= al; mrun = mn;
                if (hi == 0) wsf[r32] = al;
                asm volatile("s_waitcnt lgkmcnt(0)" ::: "memory");
#pragma unroll
                for (int r = 0; r < 16; ++r) { const float f = wsf[crow(r, hi)];
#pragma unroll
                    for (int dd = 0; dd < 4; ++dd) o[dd][r] *= f; }
            }
            float s = 0.f;
#pragma unroll
            for (int r = 0; r < 16; ++r) { p0[r] = __builtin_amdgcn_exp2f(p0[r] - mrun); p1[r] = __builtin_amdgcn_exp2f(p1[r] - mrun); s += p0[r] + p1[r]; }
            lsum += s;
            bf16x8 pa[4]; pack_p(pa, p0, p1);
            pv_tile<4>(o, (lds_cptr)(lds + cur + L_V), pa, lane);
        }
        if (more) {
#pragma unroll
            for (int i = 0; i < 2; ++i) { *(ALAS u32x4*)(lds + (cur ^ BUFB) + kdst[i]) = kreg[i]; *(ALAS u32x4*)(lds + (cur ^ BUFB) + vdst[i]) = vreg[i]; } }
        __syncthreads();
    }
    { const float lt = lsum + swap_other(lsum, hi); if (hi == 0) wsf[32 + r32] = lt; }
    asm volatile("s_waitcnt lgkmcnt(0)" ::: "memory");
    float rli[16];
#pragma unroll
    for (int r = 0; r < 16; ++r) rli[r] = __builtin_amdgcn_rcpf(wsf[32 + crow(r, hi)]);
    ALAS float* X = (ALAS float*)(lds + sub * 16384);
    if (path == 1) {
#pragma unroll
        for (int dd = 0; dd < 4; ++dd)
#pragma unroll
            for (int r = 0; r < 16; ++r) X[(dd * 16 + r) * 64 + lane] = o[dd][r] * rli[r];
    }
    __syncthreads();
    if (path == 0) {
        ALAS float* stg = (ALAS float*)(lds + L_STG + sub * STG_DIFF);
#pragma unroll
        for (int dd = 0; dd < 4; ++dd)
#pragma unroll
            for (int r = 0; r < 16; ++r) { const float y = o[dd][r] * rli[r] - lam * X[(dd * 16 + r) * 64 + lane]; stg[crow(r, hi) * 132 + dd * 32 + r32] = y; }
        asm volatile("s_waitcnt lgkmcnt(0)" ::: "memory");
        const int piece = lane & 7;
        f32x4 gv[4];
#pragma unroll
        for (int i = 0; i < 4; ++i) gv[i] = *(const f32x4*)(gain + piece * 16 + 4 * i);
        bf16_t* Yw = Y + (rowbase + q0 + sub * 32) * YP + 512 + h * 128 + piece * 16;
#pragma unroll
        for (int ps = 0; ps < 4; ++ps) { const int row = ps * 8 + (lane >> 3);
            f32x4 v[4]; float ss = 0.f;
#pragma unroll
            for (int i = 0; i < 4; ++i) { v[i] = *(ALAS const f32x4*)(stg + row * 132 + piece * 16 + 4 * i); ss += (v[i][0] * v[i][0] + v[i][1] * v[i][1]) + (v[i][2] * v[i][2] + v[i][3] * v[i][3]); }
            ss += __shfl_xor(ss, 1); ss += __shfl_xor(ss, 2); ss += __shfl_xor(ss, 4);
            const float rs = 0.8f / sqrtf(ss * (1.0f / 128.0f) + 1e-5f);
            u32x4 w0, w1;
            { const f32x4 a = v[0] * gv[0] * rs, c = v[1] * gv[1] * rs; w0.x = cvtpk(a[0], a[1]); w0.y = cvtpk(a[2], a[3]); w0.z = cvtpk(c[0], c[1]); w0.w = cvtpk(c[2], c[3]); }
            { const f32x4 a = v[2] * gv[2] * rs, c = v[3] * gv[3] * rs; w1.x = cvtpk(a[0], a[1]); w1.y = cvtpk(a[2], a[3]); w1.z = cvtpk(c[0], c[1]); w1.w = cvtpk(c[2], c[3]); }
            *(u32x4*)(Yw + (size_t)row * YP) = w0; *(u32x4*)(Yw + (size_t)row * YP + 8) = w1; }
    }
    __syncthreads();
}


__device__ __forceinline__ float bf2f(bf16_t v) { return __uint_as_float((unsigned)v << 16); }
__device__ __forceinline__ void naive_phase(const bf16_t* P, bf16_t* Y, const float* lq1, const float* lk1, const float* lq2, const float* lk2, const float* gain) {
    const int gt0 = blockIdx.x * 512 + threadIdx.x, GT = gridDim.x * 512;
    float lam; { float s1 = 0.f, s2 = 0.f; for (int i = 0; i < 64; ++i) { s1 += lq1[i] * lk1[i]; s2 += lq2[i] * lk2[i]; } lam = expf(s1) - expf(s2) + 0.2f; }
    for (int it = gt0; it < 16384 * 8; it += GT) {
        const int tok = it >> 3, h = it & 7, t = tok & 2047; const size_t sb = (size_t)(tok - t);
        float q[64], o[64];
        for (int d = 0; d < 64; ++d) { q[d] = bf2f(P[(size_t)tok * PITCH + h * 64 + d]); o[d] = 0.f; }
        float R = 1.f;
        for (int s = t - 1; s >= 0; --s) {
            const bf16_t* kr = P + (sb + s) * PITCH + 512 + h * 64; const bf16_t* vr = P + (sb + s) * PITCH + 1024 + h * 64;
            float z = 0.f;
#pragma unroll
            for (int d = 0; d < 64; ++d) z += q[d] * bf2f(kr[d]);
            z *= 0.6931471805599453f;
            const float beta = 1.f / (1.f + expf(-z)), om = 1.f / (1.f + expf(z)), a = beta * R; R *= om;
#pragma unroll
            for (int d = 0; d < 64; ++d) o[d] += a * bf2f(vr[d]);
            if (R == 0.f) break;
        }
#pragma unroll
        for (int d = 0; d < 64; d += 2) *(unsigned*)(Y + (size_t)tok * YP + h * 64 + d) = cvtpk(o[d], o[d + 1]);
    }
    for (int it = gt0; it < 16384 * 32; it += GT) {
        const int tok = it >> 5, h = (it >> 3) & 3, ch = it & 7, t = tok & 2047; const size_t sb = (size_t)(tok - t);
        unsigned q1[32], q2[32]; float o1[16], o2[16];
        for (int d = 0; d < 32; ++d) { q1[d] = *(const unsigned*)(P + (size_t)tok * PITCH + 1536 + h * 128 + 2 * d); q2[d] = *(const unsigned*)(P + (size_t)tok * PITCH + 1536 + h * 128 + 64 + 2 * d); }
        for (int d = 0; d < 16; ++d) { o1[d] = 0.f; o2[d] = 0.f; }
        float m1 = -1e30f, m2 = -1e30f, l1 = 0.f, l2 = 0.f;
        for (int s = 0; s <= t; ++s) {
            const unsigned* kr = (const unsigned*)(P + (sb + s) * PITCH + 2048 + h * 128); const bf16_t* vr = P + (sb + s) * PITCH + 2560 + h * 128 + ch * 16;
            float z1 = 0.f, z2 = 0.f;
#pragma unroll
            for (int d = 0; d < 32; ++d) { const unsigned k1 = kr[d], k2 = kr[32 + d];
                z1 += __uint_as_float(q1[d] << 16) * __uint_as_float(k1 << 16) + __uint_as_float(q1[d] & 0xffff0000u) * __uint_as_float(k1 & 0xffff0000u);
                z2 += __uint_as_float(q2[d] << 16) * __uint_as_float(k2 << 16) + __uint_as_float(q2[d] & 0xffff0000u) * __uint_as_float(k2 & 0xffff0000u); }
            const float n1 = fmaxf(m1, z1), n2 = fmaxf(m2, z2), a1 = exp2f(m1 - n1), a2 = exp2f(m2 - n2), p1 = exp2f(z1 - n1), p2 = exp2f(z2 - n2);
            m1 = n1; m2 = n2; l1 = l1 * a1 + p1; l2 = l2 * a2 + p2;
#pragma unroll
            for (int d = 0; d < 16; ++d) { const float v = bf2f(vr[d]); o1[d] = o1[d] * a1 + p1 * v; o2[d] = o2[d] * a2 + p2 * v; }
        }
        float ss = 0.f;
#pragma unroll
        for (int d = 0; d < 16; ++d) { o1[d] = o1[d] / l1 - lam * o2[d] / l2; ss += o1[d] * o1[d]; }
        ss += __shfl_xor(ss, 1); ss += __shfl_xor(ss, 2); ss += __shfl_xor(ss, 4);
        const float rs = 0.8f / sqrtf(ss * (1.f / 128.f) + 1e-5f);
#pragma unroll
        for (int d = 0; d < 16; d += 2) *(unsigned*)(Y + (size_t)tok * YP + 512 + h * 128 + ch * 16 + d) = cvtpk(o1[d] * rs * gain[ch * 16 + d], o1[d + 1] * rs * gain[ch * 16 + d + 1]);
    }
}
constexpr bool SB_EARLY_EXIT = false;
__device__ __forceinline__ void attn_phase(lds_ptr lds, const bf16_t* P, bf16_t* Y, unsigned* ctr, const float* lq1, const float* lk1, const float* lq2, const float* lk2, const float* gain) {
    int tid_ = threadIdx.x; asm volatile("" : "+v"(tid_));
    const int tid = tid_, lane = tid & 63;
    float lam;
    { const float s1 = wave_sum64(lq1[lane] * lk1[lane]), s2 = wave_sum64(lq2[lane] * lk2[lane]); lam = expf(s1) - expf(s2) + 0.2f; }
    ALAS unsigned* uw = (ALAS unsigned*)(lds + L_UNIT);
    for (;;) {
        if (tid == 0) uw[0] = atomicAdd(ctr, 1u);
        __syncthreads();
        const unsigned idx = (unsigned)__builtin_amdgcn_readfirstlane(uw[0]);
        if (idx >= 1024u) break;
        const int n = (int)(idx >> 1);
        if ((idx & 1u) == 0u) { const int lvl = n >> 5, bh = n & 31; diff_unit(bh >> 2, bh & 3, 15 - lvl, P, Y, lds, lam, gain); }
        else { const int lvl = n >> 6, bh = n & 63; sb_unit<SB_EARLY_EXIT>(bh >> 3, bh & 7, 7 - lvl, P, Y, lds); }
    }
}
#undef ATT_MFMA
}

#define GAS __attribute__((address_space(1)))
#define LAS __attribute__((address_space(3)))
typedef unsigned short bf16;
typedef unsigned v4u __attribute__((ext_vector_type(4)));
typedef float f32x4 __attribute__((ext_vector_type(4)));
typedef short bf16x8 __attribute__((ext_vector_type(8)));
typedef GAS unsigned gu32;
typedef GAS unsigned long long gu64;
#define RLX_AGENT __ATOMIC_RELAXED, __HIP_MEMORY_SCOPE_AGENT
#define LDS_WAIT() asm volatile("s_waitcnt lgkmcnt(0)" ::: "memory")
#define VM_WAIT() asm volatile("s_waitcnt vmcnt(0)" ::: "memory")
__device__ __forceinline__ unsigned long long rt() { return __builtin_amdgcn_s_memrealtime(); }
__device__ __forceinline__ unsigned f2bf(float f) { unsigned u = __builtin_bit_cast(unsigned, f); return (u + 0x7fffu + ((u >> 16) & 1u)) >> 16; }
__device__ __forceinline__ unsigned pk2(float lo, float hi) { return f2bf(lo) | (f2bf(hi) << 16); }

#define XB_TMO      128
#define XB_XCNT(j)  (256  + 64 * (j))
#define XB_XSUB(j)  (1280 + 64 * (j))
#define XB_XGEN(j)  (2304 + 64 * (j))
#define XB_TOP      3328
#define XB_TOPGEN   3392
#define XCD_BAR_WORDS 3456
#define XB_SPIN_CAP (1u << 18)

__device__ __forceinline__ unsigned xb_ld(unsigned* p)              { return __hip_atomic_load(p, __ATOMIC_RELAXED, __HIP_MEMORY_SCOPE_AGENT); }
__device__ __forceinline__ unsigned xb_add(unsigned* p, unsigned v) { return __hip_atomic_fetch_add(p, v, __ATOMIC_RELAXED, __HIP_MEMORY_SCOPE_AGENT); }
__device__ __forceinline__ unsigned xb_xcc_id() { return (unsigned)__builtin_amdgcn_s_getreg((3 << 11) | 20) & 0xFu; }
#define XB_SPIN(cond, bar) do { unsigned _sp = 0; while (cond) { __builtin_amdgcn_s_sleep(1); \
    if ((++_sp & 255u) == 0u) { if (xb_ld(&(bar)[XB_TMO])) break; if (_sp > XB_SPIN_CAP) { atomicAdd(&(bar)[XB_TMO], 1u); break; } } } } while (0)

struct XcdBarrier {
    unsigned* bar; unsigned x;
    volatile LAS unsigned* st;
};

__device__ __forceinline__ XcdBarrier xcd_barrier_post(unsigned* bar, volatile LAS unsigned* st) {
    XcdBarrier b; b.bar = bar; b.x = xb_xcc_id(); b.st = st;
    if (threadIdx.x == 0) (void)xb_add(&bar[XB_XCNT(b.x)], 1u);
    return b;
}
__device__ __forceinline__ void xcd_barrier_complete(unsigned* bar, unsigned x, unsigned& nloc, unsigned& nx) {
    const unsigned G = gridDim.x * gridDim.y * gridDim.z;
    unsigned sum, cnt, mine, sp = 0u;
    for (;;) {
        sum = 0u; cnt = 0u; mine = 0u;
#pragma unroll
        for (unsigned j = 0; j < 16; ++j) { const unsigned c = xb_ld(&bar[XB_XCNT(j)]); sum += c; cnt += (c > 0u) ? 1u : 0u; mine = (j == x) ? c : mine; }
        if (sum == G) break;
        __builtin_amdgcn_s_sleep(1);
        if ((++sp & 255u) == 0u) { if (xb_ld(&bar[XB_TMO])) break; if (sp > XB_SPIN_CAP) { atomicAdd(&bar[XB_TMO], 1u); break; } }
    }
    nloc = mine > 0u ? mine : 1u; nx = cnt > 0u ? cnt : 1u;
}

__device__ __forceinline__ void xcd_barrier(const XcdBarrier& b) {
    asm volatile("s_waitcnt vmcnt(0)" ::: "memory");
    __syncthreads();
    if (threadIdx.x == 0) {
        unsigned* bar = b.bar;
        __builtin_amdgcn_s_waitcnt(0);
        unsigned nloc = b.st[0], nx = b.st[1];
        if (nloc == 0u) { xcd_barrier_complete(bar, b.x, nloc, nx); b.st[0] = nloc; b.st[1] = nx; }
        const unsigned old = xb_add(&bar[XB_XSUB(b.x)], 1u);
        const unsigned gen = old / nloc;
        if (old + 1u == (gen + 1u) * nloc) {
            __builtin_amdgcn_fence(__ATOMIC_RELEASE, "agent");
            asm volatile("s_waitcnt vmcnt(0)" ::: "memory");
            const unsigned og = xb_add(&bar[XB_TOP], 1u);
            const unsigned tg = og / nx;
            if (og + 1u == (tg + 1u) * nx) xb_add(&bar[XB_TOPGEN], 1u);
            else XB_SPIN(xb_ld(&bar[XB_TOPGEN]) == tg, bar);
            __builtin_amdgcn_fence(__ATOMIC_ACQUIRE, "agent");
            xb_add(&bar[XB_XGEN(b.x)], 1u);
            asm volatile("s_waitcnt vmcnt(0)" ::: "memory");
        } else {
            XB_SPIN(xb_ld(&bar[XB_XGEN(b.x)]) == gen, bar);
            __builtin_amdgcn_fence(__ATOMIC_ACQUIRE, "agent");
            asm volatile("s_waitcnt vmcnt(0)" ::: "memory");
        }
    }
    __syncthreads();
}

constexpr int NWAVES = 8;
#ifndef MK_PER_PHASE
#define MK_PER_PHASE 0
#endif
constexpr int N_PHASES = 9;
constexpr int M = 16384, D = 1024, NIN = 5120, FF = 4096, SEQL = 2048;
constexpr float LN_EPS = 1e-5f;
constexpr float DN_ALPHA = 1.189207115002721f;
constexpr size_t MiB = 1u << 20;
constexpr size_t WS_CTL = 0, CTL_ZERO_BYTES = 64 * 1024;
constexpr size_t WS_ROPE = 1 * MiB;
constexpr size_t WS_WIN = 2 * MiB, WS_WBR = 12 * MiB, WS_WOUT = 14 * MiB, WS_WFF1 = 16 * MiB, WS_WFF2 = 24 * MiB;
constexpr size_t WS_XB = 32 * MiB;
constexpr size_t WS_P = 64 * MiB;
constexpr size_t WS_G = 160 * MiB;
constexpr size_t WS_MG = 224 * MiB;
constexpr size_t WS_H = 128 * MiB;
constexpr size_t WS_END = 256 * MiB;
constexpr int CW_TMO = 0, CW_CODE = 1, CW_ATTQ = 64, CW_BAR = 4096;
constexpr int RING_OFF = 0, RING_BYTES = 131072;
constexpr int LDSCTL_OFF = 143360, MISC_OFF = LDSCTL_OFF + 320;
constexpr int LDS_BYTES = 147456;
static_assert(att::ATT_LDS <= LDSCTL_OFF && MISC_OFF + 128 <= LDS_BYTES, "LDS map");

struct Frame {
    LAS unsigned char* lds;
    volatile LAS unsigned* MISC;
    gu32* ctl;
    int tid, lane, wave;
    int vcu, G;
};

__device__ __forceinline__ float wave_sum(float v) {
#pragma unroll
    for (int o = 1; o < 64; o <<= 1) v += __shfl_xor(v, o);
    return v;
}
__device__ __forceinline__ int rope_rowmap(int n) {
    if (n < 1536 || n >= 2560) return n;
    const int d = n & 63, base = n - d;
    return base + ((d < 32) ? (8 * (d >> 2) + (d & 3)) : (8 * ((d - 32) >> 2) + 4 + (d & 3)));
}
template <bool ROPEMAP> __device__ __forceinline__ void p0_transpose_item(const float* W, int N, bf16* WT, int ldt, int koff, LAS float* scr, int item, int lane) {
    const int nblk = N / 32, kb = item / nblk, nb = item % nblk, k0 = 64 * kb, n0 = 32 * nb;
#pragma unroll 8
    for (int i = 0; i < 32; ++i) { const int kk = 2 * i + (lane >> 5); scr[kk * 33 + (lane & 31)] = W[(size_t)(k0 + kk) * N + n0 + (lane & 31)]; }
    LDS_WAIT(); asm volatile("" ::: "memory");
    const int c = lane & 7;
#pragma unroll
    for (int j = 0; j < 4; ++j) { const int n = (lane >> 3) + 8 * j; const LAS float* s = scr + (8 * c) * 33 + n;
        v4u o; o.x = pk2(s[0 * 33], s[1 * 33]); o.y = pk2(s[2 * 33], s[3 * 33]); o.z = pk2(s[4 * 33], s[5 * 33]); o.w = pk2(s[6 * 33], s[7 * 33]);
        const int row = ROPEMAP ? rope_rowmap(n0 + n) : (n0 + n);
        *(GAS v4u*)(WT + (size_t)row * ldt + koff + k0 + 8 * c) = o; }
    LDS_WAIT(); asm volatile("" ::: "memory");
}
__device__ __forceinline__ void cvt_row_to_bf16(Frame& F, const float* xrow, bf16* orow) {
    const GAS f32x4* xr = (const GAS f32x4*)xrow + F.lane;
    GAS unsigned long long* o8 = (GAS unsigned long long*)orow + F.lane;
    f32x4 v[4];
#pragma unroll
    for (int j = 0; j < 4; ++j) v[j] = xr[64 * j];
#pragma unroll
    for (int j = 0; j < 4; ++j) o8[64 * j] = (unsigned long long)pk2(v[j].x, v[j].y) | ((unsigned long long)pk2(v[j].z, v[j].w) << 32);
}
__device__ __forceinline__ void ln_row(Frame& F, const float* xrow, float* of, bf16* ob, const float* gain, const float* bias) {
    const GAS f32x4* xr = (const GAS f32x4*)xrow + F.lane;
    f32x4 v[4]; float s = 0.f;
#pragma unroll
    for (int j = 0; j < 4; ++j) { v[j] = xr[64 * j]; s += (v[j].x + v[j].y) + (v[j].z + v[j].w); }
    const float mean = wave_sum(s) * (1.f / D); float s2 = 0.f;
#pragma unroll
    for (int j = 0; j < 4; ++j) { v[j] = v[j] - mean; s2 += (v[j].x * v[j].x + v[j].y * v[j].y) + (v[j].z * v[j].z + v[j].w * v[j].w); }
    const float rstd = 1.f / sqrtf(wave_sum(s2) * (1.f / D) + LN_EPS);
    GAS f32x4* o4 = (GAS f32x4*)of + F.lane;
    GAS unsigned long long* o8 = (GAS unsigned long long*)ob + F.lane;
#pragma unroll
    for (int j = 0; j < 4; ++j) { const f32x4 g = *((const GAS f32x4*)gain + F.lane + 64 * j), bb = *((const GAS f32x4*)bias + F.lane + 64 * j);
        const f32x4 y = v[j] * rstd * g + bb; o4[64 * j] = y;
        if (ob) o8[64 * j] = (unsigned long long)pk2(y.x, y.y) | ((unsigned long long)pk2(y.z, y.w) << 32); }
}
__device__ __forceinline__ void rope_entry(int s, int i, float& c, float& sn) {
    double inv = 1.0; for (int k = 0; k < i; ++k) inv *= 0.7498942093324558273;
    const float ang = (float)s * (float)inv;
    const double a = (double)ang, kq = __builtin_rint(a * 0.6366197723675814);
    double r = a - kq * 1.5707963267948966; r -= kq * 6.123233995736766e-17;
    const double r2 = r * r;
    const double sp = r * (1.0 + r2 * (-1.0 / 6 + r2 * (1.0 / 120 + r2 * (-1.0 / 5040 + r2 * (1.0 / 362880 + r2 * (-1.0 / 39916800 + r2 * (1.0 / 6227020800.0)))))));
    const double cp = 1.0 + r2 * (-0.5 + r2 * (1.0 / 24 + r2 * (-1.0 / 720 + r2 * (1.0 / 40320 + r2 * (-1.0 / 3628800 + r2 * (1.0 / 479001600 + r2 * (-1.0 / 87178291200.0)))))));
    const int q = ((int)kq) & 3;
    const double cc = (q == 0) ? cp : (q == 1) ? -sp : (q == 2) ? -cp : sp;
    const double ss = (q == 0) ? sp : (q == 1) ? cp : (q == 2) ? -sp : -cp;
    c = (float)cc; sn = (float)ss;
}


__device__ __forceinline__ float nv_bf2f(bf16 v) { return __uint_as_float((unsigned)v << 16); }
__device__ __forceinline__ float nv_r(float f) { return __uint_as_float(f2bf(f) << 16); }
__device__ __forceinline__ float nv_dot(const bf16* arow, const float* W, int K, int N, int n) { float s = 0.f; for (int k = 0; k < K; ++k) s += nv_bf2f(arow[k]) * nv_r(W[(size_t)k * N + n]); return s; }
__device__ __forceinline__ void naive_p1(const bf16* XB, const float* w_in, bf16* PB, bf16* GB) {
    const size_t gt0 = (size_t)blockIdx.x * 512 + threadIdx.x, GT = (size_t)gridDim.x * 512;
    for (size_t idx = gt0; idx < (size_t)M * NIN; idx += GT) {
        const int m = (int)(idx / NIN), n = (int)(idx % NIN);
#if defined(P1_MASK)
        { const int sb_ = n >= 4096 ? 7 : n >= 3072 ? 6 : n / 512; if ((P1_MASK >> sb_) & 1) continue; }
#endif
        const float v = nv_dot(XB + (size_t)m * D, w_in, D, NIN, n);
        if (n < 512) PB[(size_t)m * 3072 + n] = (bf16)f2bf(v * att::C2);
        else if (n < 1536 || (n >= 2560 && n < 3072)) PB[(size_t)m * 3072 + n] = (bf16)f2bf(v);
        else if (n < 2560) { const int d = n & 63, pn = d < 32 ? n + 32 : n - 32, i = d & 31, s = m & 2047;
            const float vp = nv_dot(XB + (size_t)m * D, w_in, D, NIN, pn);
            const float ang = (float)s * powf(10000.f, -(float)i / 32.f), c = cosf(ang), sn = sinf(ang);
            float o = d < 32 ? v * c - vp * sn : v * c + vp * sn; if (n < 2048) o *= att::C2;
            PB[(size_t)m * 3072 + n] = (bf16)f2bf(o); }
        else GB[(size_t)m * 2048 + n - 3072] = (bf16)f2bf(1.f / (1.f + expf(-v)));
    }
}
__device__ __forceinline__ void naive_p3(const bf16* YB, const bf16* GB, const float* wa, const float* wb, bf16* MG) {
    const size_t gt0 = (size_t)blockIdx.x * 512 + threadIdx.x, GT = (size_t)gridDim.x * 512;
    for (size_t idx = gt0; idx < (size_t)M * D; idx += GT) { const int m = (int)(idx / D), c = (int)(idx % D);
        const float a = nv_dot(YB + (size_t)m * D, wa, 512, D, c), b = nv_dot(YB + (size_t)m * D + 512, wb, 512, D, c);
        MG[idx] = (bf16)f2bf(nv_bf2f(GB[(size_t)m * 2048 + c]) * a + nv_bf2f(GB[(size_t)m * 2048 + 1024 + c]) * b); }
}
__device__ __forceinline__ void naive_res(const bf16* A, int K, const float* W, const float* base, float* out) {
    const size_t gt0 = (size_t)blockIdx.x * 512 + threadIdx.x, GT = (size_t)gridDim.x * 512;
    for (size_t idx = gt0; idx < (size_t)M * D; idx += GT) { const int m = (int)(idx / D), c = (int)(idx % D);
        out[idx] = DN_ALPHA * base[idx] + nv_dot(A + (size_t)m * K, W, K, D, c); }
}
__device__ __forceinline__ void naive_p6(const bf16* X1B, const float* w1, bf16* HB) {
    const size_t gt0 = (size_t)blockIdx.x * 512 + threadIdx.x, GT = (size_t)gridDim.x * 512;
    for (size_t idx = gt0; idx < (size_t)M * FF; idx += GT) { const int m = (int)(idx / FF), f = (int)(idx % FF);
        const float z = fmaxf(nv_dot(X1B + (size_t)m * D, w1, D, FF, f), 0.f); HB[idx] = (bf16)f2bf(z * z); }
}
struct Args { const float* in[16]; float* out; unsigned char* ws; int ph_lo, ph_hi; };
__global__ void __launch_bounds__(NWAVES * 64, 2) layer_fwd(Args args) {
    extern __shared__ __attribute__((aligned(16))) unsigned char lds[];
    Frame F;
    F.lds = (LAS unsigned char*)lds;
    F.MISC = (volatile LAS unsigned*)(F.lds + MISC_OFF);
    F.tid = threadIdx.x; F.lane = F.tid & 63; F.wave = __builtin_amdgcn_readfirstlane(F.tid >> 6);
    F.G = gridDim.x; { const int bx = blockIdx.x; F.vcu = (F.G % 8 == 0) ? (bx % 8) * (F.G / 8) + bx / 8 : bx; }
    unsigned char* ws = args.ws;
    F.ctl = (gu32*)(ws + WS_CTL);
    const float* x = args.in[0]; const float* w_in = args.in[1]; const float* w_ba = args.in[2]; const float* w_bb = args.in[3]; const float* w_out = args.in[4];
    const float* lq1 = args.in[5]; const float* lk1 = args.in[6]; const float* lq2 = args.in[7]; const float* lk2 = args.in[8]; const float* subln = args.in[9];
    const float* ln1g = args.in[10]; const float* ln1b = args.in[11]; const float* w_ff1 = args.in[12]; const float* w_ff2 = args.in[13]; const float* ln2g = args.in[14]; const float* ln2b = args.in[15];
    float* cosT = (float*)(ws + WS_ROPE); float* sinT = cosT + SEQL * 32;
    bf16* WinT = (bf16*)(ws + WS_WIN); bf16* WbrT = (bf16*)(ws + WS_WBR); bf16* WoutT = (bf16*)(ws + WS_WOUT); bf16* Wff1T = (bf16*)(ws + WS_WFF1); bf16* Wff2T = (bf16*)(ws + WS_WFF2);
    bf16* XB = (bf16*)(ws + WS_XB); bf16* YB = XB; bf16* X1B = XB;
    bf16* PB = (bf16*)(ws + WS_P); float* X1F = (float*)(ws + WS_P);
    bf16* GB = (bf16*)(ws + WS_G); bf16* MG = (bf16*)(ws + WS_MG); bf16* HB = (bf16*)(ws + WS_H);

    for (int u = F.tid; u < (LDS_BYTES - LDSCTL_OFF) / 4; u += NWAVES * 64) ((LAS unsigned*)(F.lds + LDSCTL_OFF))[u] = 0u;
    __syncthreads();
    XcdBarrier bar; bar.bar = (unsigned*)(F.ctl + CW_BAR); bar.x = 0; bar.st = nullptr;
    if (!MK_PER_PHASE) bar = xcd_barrier_post((unsigned*)(F.ctl + CW_BAR), F.MISC + 8);
#define GRID_BAR() do { if (!MK_PER_PHASE) xcd_barrier(bar); } while (0)
#define REFRESH() do { int t_ = threadIdx.x; asm volatile("" : "+v"(t_)); F.tid = t_; F.lane = t_ & 63; F.wave = __builtin_amdgcn_readfirstlane(t_ >> 6); } while (0)
    const int lo = args.ph_lo, hi = args.ph_hi;
#define IN(k) (lo <= (k) && (k) < hi)
#define BOTH(k) (IN(k) && IN((k) + 1))

    if (IN(0)) {
        REFRESH();
        LAS float* scr = (LAS float*)(F.lds + RING_OFF + F.wave * 16384);
        const int gw = F.vcu * NWAVES + F.wave, NGW = F.G * NWAVES;
        constexpr int I_IN = (D / 64) * (NIN / 32), I_BR = (512 / 64) * (D / 32), I_O = (D / 64) * (D / 32), I_1 = (D / 64) * (FF / 32), I_2 = (FF / 64) * (D / 32);
        constexpr int NITEMS = I_IN + 2 * I_BR + I_O + I_1 + I_2;
        for (int it = gw; it < NITEMS; it += NGW) {
            int r = it;
            if (r < I_IN) { p0_transpose_item<true>(w_in, NIN, WinT, D, 0, scr, r, F.lane); continue; } r -= I_IN;
            if (r < I_BR) { p0_transpose_item<false>(w_ba, D, WbrT, D, 0, scr, r, F.lane); continue; } r -= I_BR;
            if (r < I_BR) { p0_transpose_item<false>(w_bb, D, WbrT, D, 512, scr, r, F.lane); continue; } r -= I_BR;
            if (r < I_O) { p0_transpose_item<false>(w_out, D, WoutT, D, 0, scr, r, F.lane); continue; } r -= I_O;
            if (r < I_1) { p0_transpose_item<false>(w_ff1, FF, Wff1T, D, 0, scr, r, F.lane); continue; } r -= I_1;
            p0_transpose_item<false>(w_ff2, D, Wff2T, FF, 0, scr, r, F.lane);
        }
        for (int m = gw; m < M; m += NGW) cvt_row_to_bf16(F, x + (size_t)m * D, XB + (size_t)m * D);
        for (int e = F.vcu * (NWAVES * 64) + F.tid; e < SEQL * 32; e += F.G * NWAVES * 64) { float c, s; rope_entry(e >> 5, e & 31, c, s); cosT[e] = c; sinT[e] = s; }
        if (BOTH(0)) GRID_BAR();
    }
    if (IN(1)) {
        pg8::Gemm g{XB, WinT, M, NIN, D}; pg8::StaticOrder S; S.init(M, NIN, F.G, (int)blockIdx.x);
        pg8::EpiProj E{PB, GB, cosT, sinT, att::C2};

#if defined(P1_MASK)
        naive_p1(XB, w_in, PB, GB); asm volatile("s_waitcnt vmcnt(0)" ::: "memory"); __syncthreads();
        pg8::gemm_phase<pg8::EpiProj, pg8::StaticOrder, true, true>(F.lds + RING_OFF, g, S, E);
#elif defined(NAIVE_P1)
        naive_p1(XB, w_in, PB, GB);
#else
        pg8::gemm_phase<pg8::EpiProj, pg8::StaticOrder, true, true>(F.lds + RING_OFF, g, S, E);
#endif
        if (BOTH(1)) GRID_BAR();
    }
    if (IN(2)) {
#if defined(ATT_NAIVE)
        att::naive_phase(PB, YB, lq1, lk1, lq2, lk2, subln);
#else
        att::attn_phase((att::lds_ptr)(F.lds + RING_OFF), PB, YB, (unsigned*)(F.ctl + CW_ATTQ), lq1, lk1, lq2, lk2, subln);
#endif
        if (BOTH(2)) GRID_BAR();
    }
    if (IN(3)) {
        pg8::Gemm g{YB, WbrT, M, D, D}; pg8::StaticOrder S; S.init(M, D, F.G, (int)blockIdx.x);
        pg8::EpiBranch E{GB, MG};

#if defined(NAIVE_P3)
        naive_p3(YB, GB, w_ba, w_bb, MG);
#else
        pg8::gemm_phase<pg8::EpiBranch, pg8::StaticOrder, false, true>(F.lds + RING_OFF, g, S, E);
#endif
        if (BOTH(3)) GRID_BAR();
    }
    if (IN(4)) {
        pg8::Gemm g{MG, WoutT, M, D, D}; pg8::StaticOrder S; S.init(M, D, F.G, (int)blockIdx.x);
        pg8::EpiResF32 E{x, X1F, D, DN_ALPHA};

#if defined(NAIVE_P4)
        naive_res(MG, D, w_out, x, X1F);
#else
        pg8::gemm_phase<pg8::EpiResF32, pg8::StaticOrder, false, true>(F.lds + RING_OFF, g, S, E);
#endif
        if (BOTH(4)) GRID_BAR();
    }
    if (IN(5)) {
        REFRESH();
        const int gw = F.vcu * NWAVES + F.wave, NGW = F.G * NWAVES;
        for (int m = gw; m < M; m += NGW) ln_row(F, X1F + (size_t)m * D, X1F + (size_t)m * D, X1B + (size_t)m * D, ln1g, ln1b);
        if (BOTH(5)) GRID_BAR();
    }
    if (IN(6)) {
        pg8::Gemm g{X1B, Wff1T, M, FF, D}; pg8::StaticOrder S; S.init(M, FF, F.G, (int)blockIdx.x);
        pg8::EpiRelu2 E{HB, FF};

#if defined(NAIVE_P6)
        naive_p6(X1B, w_ff1, HB);
#else
        pg8::gemm_phase<pg8::EpiRelu2, pg8::StaticOrder, true, true>(F.lds + RING_OFF, g, S, E);
#endif
        if (BOTH(6)) GRID_BAR();
    }
    if (IN(7)) {
        pg8::Gemm g{HB, Wff2T, M, D, FF}; pg8::StaticOrder S; S.init(M, D, F.G, (int)blockIdx.x);
        pg8::EpiResF32 E{X1F, args.out, D, DN_ALPHA};

#if defined(NAIVE_P7)
        naive_res(HB, FF, w_ff2, X1F, args.out);
#else
        pg8::gemm_phase<pg8::EpiResF32, pg8::StaticOrder, false, true>(F.lds + RING_OFF, g, S, E);
#endif
        if (BOTH(7)) GRID_BAR();
    }
    if (IN(8)) {
        REFRESH();
        const int gw = F.vcu * NWAVES + F.wave, NGW = F.G * NWAVES;
        for (int m = gw; m < M; m += NGW) ln_row(F, args.out + (size_t)m * D, args.out + (size_t)m * D, nullptr, ln2g, ln2b);
    }
#undef IN
#undef BOTH
#undef GRID_BAR
}

extern "C" void kernel_launch(void* const* d_in, const int* in_sizes, int n_in, void* d_out, int out_size, void* d_ws, size_t ws_size, hipStream_t stream) {
    static int grid = 0;
    if (grid == 0) {
        if (n_in != 16 || in_sizes[0] != M * D || out_size != M * D || ws_size < WS_END) { fprintf(stderr, "kernel_launch: unexpected shapes (n_in %d, in0 %d, out %d, ws %zu); nothing launched\n", n_in, n_in > 0 ? in_sizes[0] : -1, out_size, ws_size); grid = -1; return; }
        int dev = 0, cus = 0, per_cu = 0;
        if (hipGetDevice(&dev) != hipSuccess || hipDeviceGetAttribute(&cus, hipDeviceAttributeMultiprocessorCount, dev) != hipSuccess) { fprintf(stderr, "kernel_launch: device query failed\n"); grid = -1; return; }
        if (hipFuncSetAttribute((const void*)layer_fwd, hipFuncAttributeMaxDynamicSharedMemorySize, LDS_BYTES) != hipSuccess) { fprintf(stderr, "kernel_launch: hipFuncSetAttribute failed\n"); grid = -1; return; }
        if (hipOccupancyMaxActiveBlocksPerMultiprocessor(&per_cu, (const void*)layer_fwd, NWAVES * 64, LDS_BYTES) != hipSuccess || per_cu < 1) { fprintf(stderr, "kernel_launch: occupancy query reports %d workgroups per CU\n", per_cu); per_cu = 1; }
        (void)hipGetLastError();
        grid = cus;
    }
    if (grid < 0) return;
    if (hipMemsetAsync((char*)d_ws + WS_CTL, 0, CTL_ZERO_BYTES, stream) != hipSuccess) { fprintf(stderr, "kernel_launch: hipMemsetAsync failed\n"); return; }
    Args a{};
    for (int i = 0; i < 16; ++i) a.in[i] = (const float*)d_in[i];
    a.out = (float*)d_out; a.ws = (unsigned char*)d_ws;
#if MK_PER_PHASE
    for (int li = 0; li < N_PHASES; ++li) { a.ph_lo = li; a.ph_hi = li + 1; hipLaunchKernelGGL(layer_fwd, dim3(grid), dim3(NWAVES * 64), LDS_BYTES, stream, a); }
#else
    a.ph_lo = 0; a.ph_hi = N_PHASES;
    hipLaunchKernelGGL(layer_fwd, dim3(grid), dim3(NWAVES * 64), LDS_BYTES, stream, a);
#endif
    const hipError_t le = hipPeekAtLastError();
    if (le != hipSuccess) fprintf(stderr, "kernel_launch: launch failed: %s\n", hipGetErrorName(le));
}
```
